# Optimizing an MI355X kernel written in HIP

```python
import math
import jax, jax.numpy as jnp
from jax import lax
import numpy as np

D_MODEL = 2048
BATCH = 4
SEQ = 2048
DEPTH = 1

N_META = 16
S5_WIDTH = 1024
S5_GROUP = 16
S5_GROUPS = S5_WIDTH // S5_GROUP
S5_STATE = 64
N_DIR = 2
CONV_WIDTH = 1024
CONV_K = 3
FFN_HIDDEN = ((math.ceil(8 * D_MODEL / 3) + 255) // 256) * 256
IN_COLS = S5_WIDTH + 3 * CONV_WIDTH + 2 * D_MODEL
RMS_EPS = 1e-6
DT_MIN = 1e-3
DT_MAX = 1e-1
LAM_RE_MAX = -1e-4

kernel_name = 'hybrid_s5_shortconv_gated_encoder_block'


def rms_norm(x, g):
    xf = x.astype(jnp.float32)
    r = lax.rsqrt(jnp.mean(xf * xf, axis=-1, keepdims=True) + RMS_EPS)
    return (xf * r * g.astype(jnp.float32)).astype(x.dtype)


def _complex_linear_combine(e1, e2):
    a1r, a1i, b1r, b1i = e1
    a2r, a2i, b2r, b2i = e2
    ar = a2r * a1r - a2i * a1i
    ai = a2r * a1i + a2i * a1r
    br = a2r * b1r - a2i * b1i + b2r
    bi = a2r * b1i + a2i * b1r + b2i
    return (ar, ai, br, bi)


def s5_bidirectional(u, lam_re, lam_im, log_dt, b_re, b_im, c_re, c_im, d_skip):
    bsz, seq_len, _ = u.shape
    f32 = jnp.float32
    uf = u.astype(f32)
    ug = uf.reshape(bsz, seq_len, S5_GROUPS, S5_GROUP)
    y = uf * d_skip.astype(f32)
    for direction in range(N_DIR):
        lr = jnp.minimum(lam_re[direction].astype(f32), LAM_RE_MAX)
        li = lam_im[direction].astype(f32)
        dt = jnp.exp(log_dt[direction].astype(f32))[:, None]
        mag = jnp.exp(lr * dt)
        ar = mag * jnp.cos(li * dt)
        ai = mag * jnp.sin(li * dt)
        den = lr * lr + li * li
        nr = ar - 1.0
        zr = (nr * lr + ai * li) / den
        zi = (ai * lr - nr * li) / den
        bu_r = jnp.einsum('blgc,gpc->blgp', ug, b_re[direction].astype(f32))
        bu_i = jnp.einsum('blgc,gpc->blgp', ug, b_im[direction].astype(f32))
        xr = zr * bu_r - zi * bu_i
        xi = zr * bu_i + zi * bu_r
        a_r = jnp.broadcast_to(ar, xr.shape)
        a_i = jnp.broadcast_to(ai, xr.shape)
        _, _, sr, si = lax.associative_scan(_complex_linear_combine, (a_r, a_i, xr, xi),
                                            axis=1, reverse=(direction == 1))
        yd = (jnp.einsum('blgp,gcp->blgc', sr, c_re[direction].astype(f32))
              - jnp.einsum('blgp,gcp->blgc', si, c_im[direction].astype(f32)))
        y = y + yd.reshape(bsz, seq_len, S5_WIDTH)
    return y.astype(u.dtype)


def centred_dwconv3(v, w, b):
    seq_len = v.shape[1]
    vp = jnp.pad(v, ((0, 0), (1, 1), (0, 0)))
    return w[0] * vp[:, :seq_len] + w[1] * vp[:, 1:seq_len + 1] + w[2] * vp[:, 2:] + b


def setup_inputs(seed: int = 0) -> dict:
    key = jax.random.key(seed)
    ks = jax.random.split(key, 32)
    f32 = jnp.float32
    G, P, Q = S5_GROUPS, S5_STATE, S5_GROUP

    def nrm(k, shape, scale):
        return jax.random.normal(k, shape, f32) * scale

    x = nrm(ks[0], (BATCH, SEQ, D_MODEL), 1.0)
    meta = nrm(ks[1], (N_META, D_MODEL), 1.0)
    g_mix_pre = 1.0 + nrm(ks[2], (DEPTH, D_MODEL), 0.02)
    g_mix_post = 1.0 + nrm(ks[3], (DEPTH, D_MODEL), 0.02)
    g_ffn_pre = 1.0 + nrm(ks[4], (DEPTH, D_MODEL), 0.02)
    g_ffn_post = 1.0 + nrm(ks[5], (DEPTH, D_MODEL), 0.02)
    w_in = nrm(ks[6], (DEPTH, D_MODEL, IN_COLS), D_MODEL ** -0.5)
    gate_b = nrm(ks[7], (DEPTH, 2 * D_MODEL), 0.01)
    n_idx = jnp.arange(P, dtype=f32)
    lam_re = -0.5 + nrm(ks[8], (DEPTH, N_DIR, G, P), 0.01)
    lam_im = math.pi * n_idx + nrm(ks[9], (DEPTH, N_DIR, G, P), 0.01)
    log_dt = jax.random.uniform(ks[10], (DEPTH, N_DIR, G), f32,
                                math.log(DT_MIN), math.log(DT_MAX))
    b_re = nrm(ks[11], (DEPTH, N_DIR, G, P, Q), (2.0 * Q) ** -0.5)
    b_im = nrm(ks[12], (DEPTH, N_DIR, G, P, Q), (2.0 * Q) ** -0.5)
    c_re = nrm(ks[13], (DEPTH, N_DIR, G, Q, P), (2.0 * P) ** -0.5)
    c_im = nrm(ks[14], (DEPTH, N_DIR, G, Q, P), (2.0 * P) ** -0.5)
    d_skip = nrm(ks[15], (DEPTH, S5_WIDTH), 1.0)
    w_glu = nrm(ks[16], (DEPTH, S5_WIDTH, S5_WIDTH), S5_WIDTH ** -0.5)
    b_glu = nrm(ks[17], (DEPTH, S5_WIDTH), 0.01)
    w_s_up = nrm(ks[18], (DEPTH, S5_WIDTH, D_MODEL), S5_WIDTH ** -0.5)
    conv_w = nrm(ks[19], (DEPTH, CONV_K, CONV_WIDTH), CONV_K ** -0.5)
    conv_b = nrm(ks[20], (DEPTH, CONV_WIDTH), 0.01)
    w_c_up = nrm(ks[21], (DEPTH, CONV_WIDTH, D_MODEL), CONV_WIDTH ** -0.5)
    w_o = nrm(ks[22], (DEPTH, D_MODEL, D_MODEL), D_MODEL ** -0.5)
    w_ffn_in = nrm(ks[23], (DEPTH, D_MODEL, 2 * FFN_HIDDEN), D_MODEL ** -0.5)
    w_ffn_out = nrm(ks[24], (DEPTH, FFN_HIDDEN, D_MODEL), FFN_HIDDEN ** -0.5)
    return {'x': x, 'meta': meta, 'g_mix_pre': g_mix_pre, 'g_mix_post': g_mix_post,
            'g_ffn_pre': g_ffn_pre, 'g_ffn_post': g_ffn_post, 'w_in': w_in, 'gate_b': gate_b,
            'lam_re': lam_re, 'lam_im': lam_im, 'log_dt': log_dt, 'b_re': b_re, 'b_im': b_im,
            'c_re': c_re, 'c_im': c_im, 'd_skip': d_skip, 'w_glu': w_glu, 'b_glu': b_glu,
            'w_s_up': w_s_up, 'conv_w': conv_w, 'conv_b': conv_b, 'w_c_up': w_c_up,
            'w_o': w_o, 'w_ffn_in': w_ffn_in, 'w_ffn_out': w_ffn_out}


def reference(x, meta, g_mix_pre, g_mix_post, g_ffn_pre, g_ffn_post, w_in, gate_b,
              lam_re, lam_im, log_dt, b_re, b_im, c_re, c_im, d_skip, w_glu, b_glu,
              w_s_up, conv_w, conv_b, w_c_up, w_o, w_ffn_in, w_ffn_out):
    bsz = x.shape[0]
    meta_b = jnp.broadcast_to(meta[None].astype(x.dtype), (bsz, N_META, D_MODEL))
    h_stream = jnp.concatenate([meta_b, x], axis=1)
    splits = [S5_WIDTH, S5_WIDTH + CONV_WIDTH, S5_WIDTH + 2 * CONV_WIDTH,
              S5_WIDTH + 3 * CONV_WIDTH, S5_WIDTH + 3 * CONV_WIDTH + D_MODEL]
    for l in range(DEPTH):
        h = rms_norm(h_stream, g_mix_pre[l])
        proj = h @ w_in[l]
        u_s, x_c, b_c, c_c, gl_s, gl_c = jnp.split(proj, splits, axis=-1)
        gb_s, gb_c = jnp.split(gate_b[l], 2)
        y_s = s5_bidirectional(u_s, lam_re[l], lam_im[l], log_dt[l], b_re[l], b_im[l],
                               c_re[l], c_im[l], d_skip[l])
        y_s = jax.nn.gelu(y_s)
        y_s = y_s * jax.nn.sigmoid(y_s @ w_glu[l] + b_glu[l])
        y_s = y_s @ w_s_up[l]
        v = centred_dwconv3(c_c * x_c, conv_w[l], conv_b[l])
        y_c = (b_c * v) @ w_c_up[l]
        merged = jax.nn.sigmoid(gl_s + gb_s) * y_s + jax.nn.sigmoid(gl_c + gb_c) * y_c
        h_stream = h_stream + rms_norm(merged @ w_o[l], g_mix_post[l])
        h = rms_norm(h_stream, g_ffn_pre[l])
        gate, up = jnp.split(h @ w_ffn_in[l], 2, axis=-1)
        f = (jax.nn.silu(gate) * up) @ w_ffn_out[l]
        h_stream = h_stream + rms_norm(f, g_ffn_post[l])
    return h_stream[:, N_META:]
```

```cpp
#include <hip/hip_runtime.h>
#include <cstdio>
#include <cstdint>

#ifndef MK_N_LAUNCHES
#define MK_N_LAUNCHES 0
#endif

#define LAS __attribute__((address_space(3)))
#define GAS __attribute__((address_space(1)))

typedef unsigned short bf16;
typedef short bf16x8 __attribute__((ext_vector_type(8)));
typedef float f32x4 __attribute__((ext_vector_type(4)));
typedef float f32x16 __attribute__((ext_vector_type(16)));
typedef unsigned v4u __attribute__((ext_vector_type(4)));
typedef unsigned v2u __attribute__((ext_vector_type(2)));

constexpr int DM = 2048, NB = 4, SEQ = 2048, MT = NB * SEQ  , NMETA = 16;
constexpr int S5W = 1024, NG = 64, NP = 64, NQ = 16, CWID = 1024, FH = 5632, INC = 8192;
constexpr float RMS_EPS = 1e-6f;

namespace pg8 {
#define PG8_LAS __attribute__((address_space(3)))
typedef unsigned short bf16_t;
typedef unsigned u32x4 __attribute__((ext_vector_type(4)));
constexpr int BM = 256, BK = 64, HALF = 128, HTB = HALF * BK * 2, STAGE_BYTES = 8 * HTB, NXCD = 8, WGM = 8;

__host__ __device__ __forceinline__ int lds_byte(int r, int c) { const int st = (r >> 4) * 2 + (c >> 5), rr = r & 15, cc = c & 31, ob = rr * 64 + cc * 2; return st * 1024 + (ob ^ (((ob >> 9) & 1) << 5)); }
__host__ __device__ __forceinline__ void stage_rc(int b, int& R, int& C) { const int st = b / 1024, sb = b % 1024, swz = sb ^ (((sb >> 9) & 1) << 5); R = (st >> 1) * 16 + swz / 64; C = (st & 1) * 32 + (swz % 64) / 2; }
__host__ __device__ __forceinline__ int perm32(int rho) { const int n = rho >> 4, i = rho & 15; return 8 * (i >> 2) + 4 * n + (i & 3); }

struct Unit { int pm, pn; };
struct Gemm { const bf16_t* A0; const bf16_t* A1; const bf16_t* B0; const bf16_t* B1; int M, N, K; };

struct StaticOrder {
    int nM, nN, nwg, G, c;
    __host__ __device__ void init(int M, int N, int G_, int c_) { nM = M / BM; nN = N / BM; nwg = nM * nN; G = G_; c = c_; }
    __host__ __device__ bool next(int i, Unit& u) const {
        const long L = (long)i * G + c; if (L >= nwg) return false;
        int wgid = (int)L; { const int q = nwg / NXCD, r = nwg % NXCD, xcd = wgid % NXCD, off = wgid / NXCD; wgid = (xcd < r ? xcd * (q + 1) : r * (q + 1) + (xcd - r) * q) + off; }
        const int nig = WGM * nN, gid = wgid / nig, fm = gid * WGM, gsz = (nM - fm) < WGM ? (nM - fm) : WGM;
        u.pm = fm + ((wgid % nig) % gsz); u.pn = (wgid % nig) / gsz; return true;
    }
};

typedef float f32x2_ __attribute__((ext_vector_type(2)));
typedef __bf16 bf16x2_ __attribute__((ext_vector_type(2)));
__device__ __forceinline__ unsigned cvt_pk_bf16(float lo, float hi) { const f32x2_ v = {lo, hi}; return __builtin_bit_cast(unsigned, __builtin_convertvector(v, bf16x2_)); }
__device__ __forceinline__ float bf_lo(unsigned w) { return __uint_as_float(w << 16); }
__device__ __forceinline__ float bf_hi(unsigned w) { return __uint_as_float(w & 0xffff0000u); }
__device__ __forceinline__ float sigmoidf_(float x) { return __builtin_amdgcn_rcpf(1.0f + __expf(-x)); }

typedef f32x4 Acc[2][2][4][2];

struct EpiInProj {
    static constexpr bool PERM = true;
    bf16_t* usg; bf16_t* xbc; bf16_t* gates; const float* gate_b;
    __device__ __forceinline__ void mid(Acc&, const Unit&, int, int, int, int) const {}
    __device__ __forceinline__ void operator()(const Acc& acc, const Unit& u, int wr, int wc, int fr, int fq) const {
        const int row0 = u.pm * BM + wr * 64 + fr, colt = u.pn * BM;
        if (colt < S5W) {
#pragma unroll
            for (int ai = 0; ai < 2; ++ai)
#pragma unroll
                for (int m = 0; m < 4; ++m) { const int row = row0 + ai * HALF + m * 16, b = row >> 11, t = row & 2047;
#pragma unroll
                    for (int bj = 0; bj < 2; ++bj) { const int c0 = colt + bj * HALF + wc * 32 + 8 * fq, g = c0 >> 4, hf = (c0 >> 3) & 1;
                        const f32x4 v0 = acc[ai][bj][m][0], v1 = acc[ai][bj][m][1];
                        u32x4 w; w.x = cvt_pk_bf16(v0[0], v0[1]); w.y = cvt_pk_bf16(v0[2], v0[3]); w.z = cvt_pk_bf16(v1[0], v1[1]); w.w = cvt_pk_bf16(v1[2], v1[3]);
                        *(u32x4*)(usg + ((size_t)((b * NG + g) * SEQ + t)) * 16 + hf * 8) = w; } }
        } else if (colt < 4096) {
#pragma unroll
            for (int ai = 0; ai < 2; ++ai)
#pragma unroll
                for (int m = 0; m < 4; ++m) { const int row = row0 + ai * HALF + m * 16;
#pragma unroll
                    for (int bj = 0; bj < 2; ++bj) { const int c0 = colt - 1024 + bj * HALF + wc * 32 + 8 * fq;
                        const f32x4 v0 = acc[ai][bj][m][0], v1 = acc[ai][bj][m][1];
                        u32x4 w; w.x = cvt_pk_bf16(v0[0], v0[1]); w.y = cvt_pk_bf16(v0[2], v0[3]); w.z = cvt_pk_bf16(v1[0], v1[1]); w.w = cvt_pk_bf16(v1[2], v1[3]);
                        *(u32x4*)(xbc + (size_t)row * 3072 + c0) = w; } }
        } else {
            f32x4 bv[2][2];
#pragma unroll
            for (int bj = 0; bj < 2; ++bj)
#pragma unroll
                for (int n = 0; n < 2; ++n) bv[bj][n] = *(const f32x4*)(gate_b + (colt - 4096) + bj * HALF + wc * 32 + 8 * fq + 4 * n);
#pragma unroll
            for (int ai = 0; ai < 2; ++ai)
#pragma unroll
                for (int m = 0; m < 4; ++m) { const int row = row0 + ai * HALF + m * 16;
#pragma unroll
                    for (int bj = 0; bj < 2; ++bj) { const int c0 = colt - 4096 + bj * HALF + wc * 32 + 8 * fq;
                        f32x4 v0 = acc[ai][bj][m][0] + bv[bj][0], v1 = acc[ai][bj][m][1] + bv[bj][1];
#pragma unroll
                        for (int j = 0; j < 4; ++j) { v0[j] = sigmoidf_(v0[j]); v1[j] = sigmoidf_(v1[j]); }
                        u32x4 w; w.x = cvt_pk_bf16(v0[0], v0[1]); w.y = cvt_pk_bf16(v0[2], v0[3]); w.z = cvt_pk_bf16(v1[0], v1[1]); w.w = cvt_pk_bf16(v1[2], v1[3]);
                        *(u32x4*)(gates + (size_t)row * 4096 + c0) = w; } }
        }
    }
};
struct EpiGlu {
    static constexpr bool PERM = true;
    const bf16_t* ysg; bf16_t* z; const float* b_glu;
    __device__ __forceinline__ void mid(Acc&, const Unit&, int, int, int, int) const {}
    __device__ __forceinline__ void operator()(const Acc& acc, const Unit& u, int wr, int wc, int fr, int fq) const {
        const int row0 = u.pm * BM + wr * 64 + fr, colt = u.pn * BM;
        f32x4 bv[2][2];
#pragma unroll
        for (int bj = 0; bj < 2; ++bj)
#pragma unroll
            for (int n = 0; n < 2; ++n) bv[bj][n] = *(const f32x4*)(b_glu + colt + bj * HALF + wc * 32 + 8 * fq + 4 * n);
#pragma unroll
        for (int ai = 0; ai < 2; ++ai)
#pragma unroll
            for (int m = 0; m < 4; ++m) { const int row = row0 + ai * HALF + m * 16;
#pragma unroll
                for (int bj = 0; bj < 2; ++bj) { const int c0 = colt + bj * HALF + wc * 32 + 8 * fq;
                    const u32x4 y8 = *(const u32x4*)(ysg + (size_t)row * S5W + c0);
                    const f32x4 v0 = acc[ai][bj][m][0] + bv[bj][0], v1 = acc[ai][bj][m][1] + bv[bj][1];
                    u32x4 w;
                    w.x = cvt_pk_bf16(bf_lo(y8.x) * sigmoidf_(v0[0]), bf_hi(y8.x) * sigmoidf_(v0[1]));
                    w.y = cvt_pk_bf16(bf_lo(y8.y) * sigmoidf_(v0[2]), bf_hi(y8.y) * sigmoidf_(v0[3]));
                    w.z = cvt_pk_bf16(bf_lo(y8.z) * sigmoidf_(v1[0]), bf_hi(y8.z) * sigmoidf_(v1[1]));
                    w.w = cvt_pk_bf16(bf_lo(y8.w) * sigmoidf_(v1[2]), bf_hi(y8.w) * sigmoidf_(v1[3]));
                    *(u32x4*)(z + (size_t)row * S5W + c0) = w; } }
    }
};
struct EpiMerge {
    static constexpr bool PERM = true;
    const bf16_t* gates; bf16_t* merged;
    __device__ __forceinline__ void mid(Acc& acc, const Unit& u, int wr, int wc, int fr, int fq) const {
        const int row0 = u.pm * BM + wr * 64 + fr, colt = u.pn * BM;
#pragma unroll
        for (int ai = 0; ai < 2; ++ai)
#pragma unroll
            for (int m = 0; m < 4; ++m) { const int row = row0 + ai * HALF + m * 16;
#pragma unroll
                for (int bj = 0; bj < 2; ++bj) { const int c0 = colt + bj * HALF + wc * 32 + 8 * fq;
                    const u32x4 s8 = *(const u32x4*)(gates + (size_t)row * 4096 + c0), c8 = *(const u32x4*)(gates + (size_t)row * 4096 + 2048 + c0);
                    const unsigned sw[4] = {s8.x, s8.y, s8.z, s8.w}, cw[4] = {c8.x, c8.y, c8.z, c8.w};
#pragma unroll
                    for (int q = 0; q < 4; ++q) { const float r0 = bf_lo(sw[q]) * __builtin_amdgcn_rcpf(fmaxf(bf_lo(cw[q]), 1e-30f)), r1 = bf_hi(sw[q]) * __builtin_amdgcn_rcpf(fmaxf(bf_hi(cw[q]), 1e-30f));
                        acc[ai][bj][m][q >> 1][(q & 1) * 2] *= r0; acc[ai][bj][m][q >> 1][(q & 1) * 2 + 1] *= r1; } } }
    }
    __device__ __forceinline__ void operator()(const Acc& acc, const Unit& u, int wr, int wc, int fr, int fq) const {
        const int row0 = u.pm * BM + wr * 64 + fr, colt = u.pn * BM;
#pragma unroll
        for (int ai = 0; ai < 2; ++ai)
#pragma unroll
            for (int m = 0; m < 4; ++m) { const int row = row0 + ai * HALF + m * 16;
#pragma unroll
                for (int bj = 0; bj < 2; ++bj) { const int c0 = colt + bj * HALF + wc * 32 + 8 * fq;
                    const u32x4 c8 = *(const u32x4*)(gates + (size_t)row * 4096 + 2048 + c0);
                    const f32x4 v0 = acc[ai][bj][m][0], v1 = acc[ai][bj][m][1];
                    u32x4 w;
                    w.x = cvt_pk_bf16(v0[0] * bf_lo(c8.x), v0[1] * bf_hi(c8.x)); w.y = cvt_pk_bf16(v0[2] * bf_lo(c8.y), v0[3] * bf_hi(c8.y));
                    w.z = cvt_pk_bf16(v1[0] * bf_lo(c8.z), v1[1] * bf_hi(c8.z)); w.w = cvt_pk_bf16(v1[2] * bf_lo(c8.w), v1[3] * bf_hi(c8.w));
                    *(u32x4*)(merged + (size_t)row * DM + c0) = w; } }
    }
};
struct EpiF32 {
    static constexpr bool PERM = false;
    float* C; int ldc;
    __device__ __forceinline__ void mid(Acc&, const Unit&, int, int, int, int) const {}
    __device__ __forceinline__ void operator()(const Acc& acc, const Unit& u, int wr, int wc, int fr, int fq) const {
        const int row0 = u.pm * BM + wr * 64 + fr, col0 = u.pn * BM + wc * 32 + 4 * fq;
#pragma unroll
        for (int ai = 0; ai < 2; ++ai)
#pragma unroll
            for (int m = 0; m < 4; ++m) { float* rowp = C + (size_t)(row0 + ai * HALF + m * 16) * ldc + col0;
#pragma unroll
                for (int bj = 0; bj < 2; ++bj)
#pragma unroll
                    for (int n = 0; n < 2; ++n) *(f32x4*)(rowp + bj * HALF + n * 16) = acc[ai][bj][m][n]; }
    }
};
struct EpiSwiGlu {
    static constexpr bool PERM = true;
    bf16_t* act;
    __device__ __forceinline__ void mid(Acc&, const Unit&, int, int, int, int) const {}
    __device__ __forceinline__ void operator()(const Acc& acc, const Unit& u, int wr, int wc, int fr, int fq) const {
        const int row0 = u.pm * BM + wr * 64 + fr, c0 = u.pn * HALF + wc * 32 + 8 * fq;
#pragma unroll
        for (int ai = 0; ai < 2; ++ai)
#pragma unroll
            for (int m = 0; m < 4; ++m) { const int row = row0 + ai * HALF + m * 16;
                f32x4 o[2];
#pragma unroll
                for (int n = 0; n < 2; ++n)
#pragma unroll
                    for (int j = 0; j < 4; ++j) { const float gt = acc[ai][0][m][n][j], up = acc[ai][1][m][n][j]; o[n][j] = gt * sigmoidf_(gt) * up; }
                u32x4 w; w.x = cvt_pk_bf16(o[0][0], o[0][1]); w.y = cvt_pk_bf16(o[0][2], o[0][3]); w.z = cvt_pk_bf16(o[1][0], o[1][1]); w.w = cvt_pk_bf16(o[1][2], o[1][3]);
                *(u32x4*)(act + (size_t)row * FH + c0) = w; }
    }
};

template <class Epi, class Sched, bool ALIGN_EPI, bool SP2, int NPASS>
__device__ __forceinline__ void gemm_phase(PG8_LAS unsigned char* lds, const Gemm g, const Sched& S, const Epi& E) {
    const int tid = threadIdx.x, wid = __builtin_amdgcn_readfirstlane(tid >> 6), lane = tid & 63, wr = wid >> 2, wc = wid & 3, fr = lane & 15, fq = lane >> 4;
    const int K = g.K, nt = K / BK;
    unsigned voffA[2], voffB[2];
#pragma unroll
    for (int i = 0; i < 2; ++i) { int R, C; stage_rc(tid * 16 + i * 8192, R, C); const int Rb = Epi::PERM ? ((R & ~31) + perm32(R & 31)) : R;
        voffA[i] = (unsigned)(R * K + C) * 2u; voffB[i] = (unsigned)(Rb * K + C) * 2u; }
    const size_t kstep = (size_t)(BK * 2);
    const size_t hstep = (size_t)HALF * K * 2;
    const size_t tstep = 2 * hstep;
    const unsigned ldsw = (unsigned)wid * 1024u;
    const int aoff = lds_byte(wr * 64 + fr, fq * 8), boff = lds_byte(wc * 32 + fr, fq * 8);
#define PG8_SA(b, h) (((b) * 2 + (h)) * HTB)
#define PG8_SB(b, h) ((4 + (b) * 2 + (h)) * HTB)
#define PG8_STAGE(bufoff, gbase, voff) do { _Pragma("unroll") for (int _i = 0; _i < 2; ++_i) \
        __builtin_amdgcn_global_load_lds((const unsigned*)((const char*)(gbase) + (voff)[_i]), (PG8_LAS unsigned*)(lds + (bufoff) + ldsw + _i * 8192), 16, 0, 0); } while (0)
#define PG8_LDA(dst, b, h) do { _Pragma("unroll") for (int m = 0; m < 4; ++m) _Pragma("unroll") for (int k = 0; k < 2; ++k) dst[m][k] = *(const PG8_LAS bf16x8*)(lds + PG8_SA(b, h) + aoff + m * 2048 + k * 1024); } while (0)
#define PG8_LDB(dst, b, h) do { _Pragma("unroll") for (int n = 0; n < 2; ++n) _Pragma("unroll") for (int k = 0; k < 2; ++k) dst[n][k] = *(const PG8_LAS bf16x8*)(lds + PG8_SB(b, h) + boff + n * 2048 + k * 1024); } while (0)
#define PG8_MMA(ai, bj, At, Bt) do { __builtin_amdgcn_s_setprio(1); _Pragma("unroll") for (int m = 0; m < 4; ++m) _Pragma("unroll") for (int n = 0; n < 2; ++n) _Pragma("unroll") for (int k = 0; k < 2; ++k) \
        acc[ai][bj][m][n] = __builtin_amdgcn_mfma_f32_16x16x32_bf16(Bt[n][k], At[m][k], acc[ai][bj][m][n], 0, 0, 0); __builtin_amdgcn_s_setprio(0); } while (0)
#define PG8_WAIT_V(n) asm volatile("s_waitcnt vmcnt(" #n ")" ::: "memory")
#define PG8_WAIT_L(n) asm volatile("s_waitcnt lgkmcnt(" #n ")" ::: "memory")
#define PG8_BAR __builtin_amdgcn_s_barrier()
#define PG8_SCHED __builtin_amdgcn_sched_barrier(0)
    Unit cur, nxt; int ui = 0;
    if (!S.next(0, cur)) return;
    Acc acc;
#pragma unroll
    for (int a = 0; a < 2; ++a)
#pragma unroll
        for (int b = 0; b < 2; ++b)
#pragma unroll
            for (int m = 0; m < 4; ++m)
#pragma unroll
                for (int n = 0; n < 2; ++n) acc[a][b][m][n] = (f32x4){0.f, 0.f, 0.f, 0.f};
    bf16x8 At[4][2], B0[2][2], B1[2][2];
    const char* cA = (const char*)g.A0 + (size_t)cur.pm * tstep; const char* cB = (const char*)g.B0 + (size_t)cur.pn * tstep;
    if constexpr (SP2) {
        PG8_STAGE(PG8_SB(0, 0), cB, voffB); PG8_STAGE(PG8_SB(0, 1), cB + hstep, voffB); PG8_STAGE(PG8_SA(0, 0), cA, voffA); PG8_STAGE(PG8_SA(0, 1), cA + hstep, voffA);
        if (wr == 1) PG8_BAR;
        PG8_WAIT_V(2); PG8_BAR;
        PG8_STAGE(PG8_SB(1, 0), cB + kstep, voffB); PG8_STAGE(PG8_SA(1, 0), cA + kstep, voffA); PG8_STAGE(PG8_SB(1, 1), cB + hstep + kstep, voffB);
        PG8_WAIT_V(6); PG8_BAR;
    } else {
        PG8_STAGE(PG8_SB(0, 0), cB, voffB); PG8_STAGE(PG8_SA(0, 0), cA, voffA); PG8_STAGE(PG8_SB(0, 1), cB + hstep, voffB); PG8_STAGE(PG8_SA(0, 1), cA + hstep, voffA);
        if (wr == 1) PG8_BAR;
        PG8_WAIT_V(4); PG8_BAR;
        PG8_STAGE(PG8_SB(1, 0), cB + kstep, voffB); PG8_STAGE(PG8_SA(1, 0), cA + kstep, voffA); PG8_STAGE(PG8_SB(1, 1), cB + hstep + kstep, voffB);
        PG8_WAIT_V(6); PG8_BAR;
    }
    for (;;) {
        const int np = ui + 1, npass = (NPASS == 1) ? 0 : (np % NPASS), cpass = (NPASS == 1) ? 0 : (ui % NPASS);
        const bool has_next = (NPASS == 1) ? S.next(np, nxt) : S.next(np / NPASS, nxt);
        const char* nA = has_next ? (const char*)(npass ? g.A1 : g.A0) + (size_t)nxt.pm * tstep : cA; const char* nB = has_next ? (const char*)(npass ? g.B1 : g.B0) + (size_t)nxt.pn * tstep : cB;
        for (int t = 0; t < nt; t += 2) {
            const bool last = (t == nt - 2);
            const char* a1 = cA + (size_t)(t + 1) * kstep;
            const char* a2 = last ? nA : cA + (size_t)(t + 2) * kstep; const char* b2 = last ? nB : cB + (size_t)(t + 2) * kstep;
            const char* a3 = a2 + kstep; const char* b3 = b2 + kstep;
            if constexpr (SP2) {
            PG8_LDB(B0, 0, 0); PG8_LDB(B1, 0, 1); PG8_SCHED; PG8_LDA(At, 0, 0); PG8_STAGE(PG8_SA(1, 1), a1 + hstep, voffA);
            PG8_WAIT_V(8); PG8_WAIT_L(0); PG8_BAR; PG8_MMA(0, 0, At, B0); PG8_MMA(0, 1, At, B1); PG8_BAR; PG8_SCHED;
            PG8_LDA(At, 0, 1); PG8_STAGE(PG8_SB(0, 0), b2, voffB); PG8_STAGE(PG8_SB(0, 1), b2 + hstep, voffB); PG8_STAGE(PG8_SA(0, 0), a2, voffA);
            PG8_WAIT_V(8); PG8_WAIT_L(0); PG8_BAR; PG8_MMA(1, 0, At, B0); PG8_MMA(1, 1, At, B1); PG8_BAR; PG8_SCHED;
            PG8_LDB(B0, 1, 0); PG8_LDB(B1, 1, 1); PG8_SCHED; PG8_LDA(At, 1, 0); PG8_STAGE(PG8_SA(0, 1), a2 + hstep, voffA);
            PG8_WAIT_V(8); PG8_WAIT_L(0); PG8_BAR; PG8_MMA(0, 0, At, B0); PG8_MMA(0, 1, At, B1); PG8_BAR; PG8_SCHED;
            PG8_LDA(At, 1, 1); PG8_STAGE(PG8_SB(1, 0), b3, voffB); PG8_STAGE(PG8_SB(1, 1), b3 + hstep, voffB); PG8_STAGE(PG8_SA(1, 0), a3, voffA);
            PG8_WAIT_V(8); PG8_WAIT_L(0); PG8_BAR; PG8_MMA(1, 0, At, B0); PG8_MMA(1, 1, At, B1); PG8_BAR; PG8_SCHED;
            } else {
            PG8_LDB(B0, 0, 0); PG8_SCHED; PG8_LDA(At, 0, 0); PG8_STAGE(PG8_SA(1, 1), a1 + hstep, voffA);
            PG8_WAIT_L(8); PG8_BAR; PG8_WAIT_L(0); PG8_MMA(0, 0, At, B0); PG8_BAR; PG8_SCHED;
            PG8_LDB(B1, 0, 1); PG8_STAGE(PG8_SB(0, 0), b2, voffB);
            PG8_BAR; PG8_WAIT_L(0); PG8_MMA(0, 1, At, B1); PG8_BAR;
            PG8_LDA(At, 0, 1); PG8_STAGE(PG8_SA(0, 0), a2, voffA);
            PG8_BAR; PG8_WAIT_L(0); PG8_MMA(1, 0, At, B0); PG8_BAR; PG8_SCHED;
            PG8_STAGE(PG8_SB(0, 1), b2 + hstep, voffB);
            PG8_WAIT_V(6); PG8_BAR; PG8_MMA(1, 1, At, B1); PG8_BAR;
            PG8_LDB(B0, 1, 0); PG8_SCHED; PG8_LDA(At, 1, 0); PG8_STAGE(PG8_SA(0, 1), a2 + hstep, voffA);
            PG8_WAIT_L(8); PG8_BAR; PG8_WAIT_L(0); PG8_MMA(0, 0, At, B0); PG8_BAR; PG8_SCHED;
            PG8_LDB(B1, 1, 1); PG8_STAGE(PG8_SB(1, 0), b3, voffB);
            PG8_BAR; PG8_WAIT_L(0); PG8_MMA(0, 1, At, B1); PG8_BAR;
            PG8_LDA(At, 1, 1); PG8_STAGE(PG8_SA(1, 0), a3, voffA);
            PG8_BAR; PG8_WAIT_L(0); PG8_MMA(1, 0, At, B0); PG8_BAR; PG8_SCHED;
            PG8_STAGE(PG8_SB(1, 1), b3 + hstep, voffB);
            PG8_WAIT_V(6); PG8_BAR; PG8_MMA(1, 1, At, B1); PG8_BAR;
            }
        }
        const bool fin = (cpass == NPASS - 1);
        if constexpr (ALIGN_EPI) { if (wr == 0) PG8_BAR; }
        if (fin) E(acc, cur, wr, wc, fr, fq); else E.mid(acc, cur, wr, wc, fr, fq);
        if (!has_next) break;
        if (fin) {
#pragma unroll
            for (int a = 0; a < 2; ++a)
#pragma unroll
                for (int b = 0; b < 2; ++b)
#pragma unroll
                    for (int m = 0; m < 4; ++m)
#pragma unroll
                        for (int n = 0; n < 2; ++n) acc[a][b][m][n] = (f32x4){0.f, 0.f, 0.f, 0.f};
        }
        cur = nxt; cA = nA; cB = nB; ++ui;
        if constexpr (ALIGN_EPI) { if (wr == 1) PG8_BAR; }
    }
    PG8_WAIT_V(0);
    if constexpr (!ALIGN_EPI) { if (wr == 0) PG8_BAR; }
    PG8_BAR;
#undef PG8_SA
#undef PG8_SB
#undef PG8_STAGE
#undef PG8_LDA
#undef PG8_LDB
#undef PG8_MMA
#undef PG8_WAIT_V
#undef PG8_WAIT_L
#undef PG8_BAR
#undef PG8_SCHED
}
}

constexpr size_t MiB = 1u << 20;
constexpr size_t WS_CTL = 0, CTL_ZERO_BYTES = 64 * 1024;
constexpr size_t WS_HM = 1 * MiB;
constexpr size_t WS_PMETA = 1 * MiB + 64 * 1024;
constexpr size_t WS_S5AT = 1 * MiB + 256 * 1024;
constexpr size_t WS_WGLU = 2 * MiB, WS_WSUP = 4 * MiB, WS_WCUP = 8 * MiB, WS_WO = 12 * MiB, WS_WFOUT = 20 * MiB, WS_WFIN = 42 * MiB;
constexpr size_t WS_S5M = 86 * MiB;
constexpr size_t WS_WIN = 110 * MiB;
constexpr size_t WS_MERGED = 110 * MiB;
constexpr size_t WS_H = 142 * MiB;
constexpr size_t WS_YSG = 142 * MiB, WS_Z = 158 * MiB;
constexpr size_t WS_USG = 174 * MiB;
constexpr size_t WS_XBC = 190 * MiB;
constexpr size_t WS_GATES = 238 * MiB;
constexpr size_t WS_O = 238 * MiB;
constexpr size_t WS_VB = 302 * MiB;
constexpr size_t WS_H2 = 318 * MiB;
constexpr size_t WS_ACT = 142 * MiB;
constexpr size_t WS_END = 350 * MiB;
static_assert(WS_ACT + (size_t)MT * FH * 2 <= WS_GATES, "ACT overlay");
constexpr int CW_BAR = 4096;

constexpr int RING_BYTES = 131072;
constexpr int S5_ROW_U = 528, S5_ROW_E = 1040;
constexpr int S5_UM_OFF = 136192, S5_EM_OFF = 137216;
constexpr int LDSCTL_OFF = 138240, MISC_OFF = LDSCTL_OFF + 320;
constexpr int LDS_BYTES = 147456;
static_assert(130 * S5_ROW_E <= S5_UM_OFF && MISC_OFF + 128 <= LDS_BYTES, "LDS map");

typedef GAS unsigned gu32;
#define RLX_AGENT __ATOMIC_RELAXED, __HIP_MEMORY_SCOPE_AGENT
#define LDS_WAIT() asm volatile("s_waitcnt lgkmcnt(0)" ::: "memory")
#define VM_WAIT() asm volatile("s_waitcnt vmcnt(0)" ::: "memory")
__device__ __forceinline__ unsigned pk2(float lo, float hi) { return pg8::cvt_pk_bf16(lo, hi); }
__device__ __forceinline__ unsigned f2bf(float f) { return pg8::cvt_pk_bf16(f, 0.f) & 0xffffu; }
__device__ __forceinline__ float bflo(unsigned w) { return __uint_as_float(w << 16); }
__device__ __forceinline__ float bfhi(unsigned w) { return __uint_as_float(w & 0xffff0000u); }

#define XB_TMO      128
#define XB_XCNT(j)  (256  + 64 * (j))
#define XB_XSUB(j)  (1280 + 64 * (j))
#define XB_XGEN(j)  (2304 + 64 * (j))
#define XB_TOP      3328
#define XB_TOPGEN   3392
#define XCD_BAR_WORDS 3456
#define XB_SPIN_CAP (1u << 20)
__device__ __forceinline__ unsigned xb_ld(unsigned* p)              { return __hip_atomic_load(p, __ATOMIC_RELAXED, __HIP_MEMORY_SCOPE_AGENT); }
__device__ __forceinline__ unsigned xb_add(unsigned* p, unsigned v) { return __hip_atomic_fetch_add(p, v, __ATOMIC_RELAXED, __HIP_MEMORY_SCOPE_AGENT); }
__device__ __forceinline__ unsigned xb_xcc_id() { return (unsigned)__builtin_amdgcn_s_getreg((3 << 11) | 20) & 0xFu; }
#define XB_SPIN(cond, bar) do { unsigned _sp = 0; while (cond) { __builtin_amdgcn_s_sleep(1); \
    if ((++_sp & 255u) == 0u) { if (xb_ld(&(bar)[XB_TMO])) break; if (_sp > XB_SPIN_CAP) { atomicAdd(&(bar)[XB_TMO], 1u); break; } } } } while (0)
struct XcdBarrier { unsigned* bar; unsigned x; volatile LAS unsigned* st; };
__device__ __forceinline__ XcdBarrier xcd_barrier_post(unsigned* bar, volatile LAS unsigned* st) {
    XcdBarrier b; b.bar = bar; b.x = xb_xcc_id(); b.st = st;
    if (threadIdx.x == 0) (void)xb_add(&bar[XB_XCNT(b.x)], 1u);
    return b;
}
__device__ __forceinline__ void xcd_barrier_complete(unsigned* bar, unsigned x, unsigned& nloc, unsigned& nx) {
    const unsigned G = gridDim.x * gridDim.y * gridDim.z;
    unsigned sum, cnt, mine, sp = 0u;
    for (;;) {
        sum = 0u; cnt = 0u; mine = 0u;
#pragma unroll
        for (unsigned j = 0; j < 16; ++j) { const unsigned c = xb_ld(&bar[XB_XCNT(j)]); sum += c; cnt += (c > 0u) ? 1u : 0u; mine = (j == x) ? c : mine; }
        if (sum == G) break;
        __builtin_amdgcn_s_sleep(1);
        if ((++sp & 255u) == 0u) { if (xb_ld(&bar[XB_TMO])) break; if (sp > XB_SPIN_CAP) { atomicAdd(&bar[XB_TMO], 1u); break; } }
    }
    nloc = mine > 0u ? mine : 1u; nx = cnt > 0u ? cnt : 1u;
}
__device__ __forceinline__ void xcd_barrier(const XcdBarrier& b) {
    asm volatile("s_waitcnt vmcnt(0)" ::: "memory");
    __syncthreads();
    if (threadIdx.x == 0) {
        unsigned* bar = b.bar;
        __builtin_amdgcn_s_waitcnt(0);
        unsigned nloc = b.st[0], nx = b.st[1];
        if (nloc == 0u) { xcd_barrier_complete(bar, b.x, nloc, nx); b.st[0] = nloc; b.st[1] = nx; }
        const unsigned old = xb_add(&bar[XB_XSUB(b.x)], 1u);
        const unsigned gen = old / nloc;
        if (old + 1u == (gen + 1u) * nloc) {
            __builtin_amdgcn_fence(__ATOMIC_RELEASE, "agent");
            asm volatile("s_waitcnt vmcnt(0)" ::: "memory");
            const unsigned og = xb_add(&bar[XB_TOP], 1u);
            const unsigned tg = og / nx;
            if (og + 1u == (tg + 1u) * nx) xb_add(&bar[XB_TOPGEN], 1u);
            else XB_SPIN(xb_ld(&bar[XB_TOPGEN]) == tg, bar);
            __builtin_amdgcn_fence(__ATOMIC_ACQUIRE, "agent");
            xb_add(&bar[XB_XGEN(b.x)], 1u);
            asm volatile("s_waitcnt vmcnt(0)" ::: "memory");
        } else {
            XB_SPIN(xb_ld(&bar[XB_XGEN(b.x)]) == gen, bar);
            __builtin_amdgcn_fence(__ATOMIC_ACQUIRE, "agent");
            asm volatile("s_waitcnt vmcnt(0)" ::: "memory");
        }
    }
    __syncthreads();
}

constexpr int NWAVES = 8;
struct Args { const float* in[25]; float* out; unsigned char* ws; int ph_lo, ph_hi; };
struct Frame {
    LAS unsigned char* lds;
    int tid, lane, wave, G, bid;
    const float *x, *meta, *g_pre, *g_post, *g_fpre, *g_fpost, *w_in, *gate_b, *lam_re, *lam_im, *log_dt, *b_re, *b_im, *c_re, *c_im, *d_skip, *w_glu, *b_glu, *w_sup, *conv_w, *conv_b, *w_cup, *w_o, *w_fin, *w_fout;
    float* out; unsigned char* ws;
};
__device__ __forceinline__ float wave_sum(float v) {
#pragma unroll
    for (int o = 1; o < 64; o <<= 1) v += __shfl_xor(v, o);
    return v;
}

__device__ __forceinline__ void p0_transpose_item(const float* W, int N, bf16* WT, int ldt, int k0, int n0, int row_base, LAS float* scr, int lane) {
#pragma unroll 8
    for (int i = 0; i < 32; ++i) { const int kk = 2 * i + (lane >> 5); scr[kk * 33 + (lane & 31)] = W[(size_t)(k0 + kk) * N + n0 + (lane & 31)]; }
    LDS_WAIT(); asm volatile("" ::: "memory");
    const int c = lane & 7;
#pragma unroll
    for (int j = 0; j < 4; ++j) { const int n = (lane >> 3) + 8 * j; const LAS float* s = scr + (8 * c) * 33 + n;
        v4u o; o.x = pk2(s[0 * 33], s[1 * 33]); o.y = pk2(s[2 * 33], s[3 * 33]); o.z = pk2(s[4 * 33], s[5 * 33]); o.w = pk2(s[6 * 33], s[7 * 33]);
        *(GAS v4u*)(WT + (size_t)(row_base + n) * ldt + k0 + 8 * c) = o; }
    LDS_WAIT(); asm volatile("" ::: "memory");
}
__device__ __forceinline__ void rms_row_to_bf16(const float* xrow, const float* gain, bf16* orow, int lane) {
    const GAS f32x4* xr = (const GAS f32x4*)xrow + lane; const GAS f32x4* gr = (const GAS f32x4*)gain + lane;
    f32x4 v[8]; float s = 0.f;
#pragma unroll
    for (int j = 0; j < 8; ++j) { v[j] = xr[64 * j]; s += (v[j].x * v[j].x + v[j].y * v[j].y) + (v[j].z * v[j].z + v[j].w * v[j].w); }
    const float r = 1.0f / sqrtf(wave_sum(s) * (1.f / DM) + RMS_EPS);
    GAS v2u* o8 = (GAS v2u*)orow + lane;
#pragma unroll
    for (int j = 0; j < 8; ++j) { const f32x4 gg = gr[64 * j]; v2u w; w.x = pk2(v[j].x * r * gg.x, v[j].y * r * gg.y); w.y = pk2(v[j].z * r * gg.z, v[j].w * r * gg.w); o8[64 * j] = w; }
}
__device__ __forceinline__ void s5_setup(Frame& F, int g) {
    LAS float* AP = (LAS float*)F.lds;
    LAS float* ZB = AP + 2 * 17 * 64 * 2;
    LAS float* CC = ZB + 2 * 64 * 16 * 2;
    LAS float* KD = CC + 2 * 16 * 64 * 2;
    const int tid = F.tid;
    if (tid < 128) {
        const int d = tid >> 6, p = tid & 63, gi = (d * NG + g) * NP + p;
        const float lr = fminf(F.lam_re[gi], -1e-4f), li = F.lam_im[gi], dt = expf(F.log_dt[d * NG + g]);
        for (int k = 0; k <= 16; ++k) { const float mag = expf(lr * dt * (float)k); float sn, cs; sincosf(li * dt * (float)k, &sn, &cs);
            AP[((d * 17 + k) * 64 + p) * 2] = mag * cs; AP[((d * 17 + k) * 64 + p) * 2 + 1] = mag * sn; }
        const float mag1 = expf(lr * dt); float sn1, cs1; sincosf(li * dt, &sn1, &cs1);
        const float ar = mag1 * cs1, ai = mag1 * sn1, den = lr * lr + li * li, nr = ar - 1.0f;
        const float zr = (nr * lr + ai * li) / den, zi = (ai * lr - nr * li) / den;
        for (int c = 0; c < 16; ++c) { const float br = F.b_re[(size_t)gi * 16 + c], bi = F.b_im[(size_t)gi * 16 + c];
            ZB[((d * 64 + p) * 16 + c) * 2] = zr * br - zi * bi; ZB[((d * 64 + p) * 16 + c) * 2 + 1] = zr * bi + zi * br; }
    }
    for (int i = tid; i < 2048; i += 512) { const int d = i >> 10, c = (i >> 6) & 15, p = i & 63; const size_t gi = ((size_t)(d * NG + g) * 16 + c) * 64 + p;
        CC[i * 2] = F.c_re[gi]; CC[i * 2 + 1] = F.c_im[gi]; }
    __syncthreads();
    if (tid < 128) { const int d = tid >> 6, p = tid & 63; float* at = (float*)(F.ws + WS_S5AT) + ((g * 2 + d) * 64 + p) * 2;
        at[0] = AP[((d * 17 + 16) * 64 + p) * 2]; at[1] = AP[((d * 17 + 16) * 64 + p) * 2 + 1]; }
    for (int i = tid; i < 8192; i += 512) { const int d = i >> 12, dl = (i >> 8) & 15, c = (i >> 4) & 15, c2 = i & 15; float s = 0.f;
        for (int p = 0; p < 64; ++p) { const float cr = CC[((d * 16 + c) * 64 + p) * 2], ci = CC[((d * 16 + c) * 64 + p) * 2 + 1];
            const float ar = AP[((d * 17 + dl) * 64 + p) * 2], ai = AP[((d * 17 + dl) * 64 + p) * 2 + 1];
            const float zr = ZB[((d * 64 + p) * 16 + c2) * 2], zi = ZB[((d * 64 + p) * 16 + c2) * 2 + 1];
            const float tr = cr * ar - ci * ai, ti = cr * ai + ci * ar; s += tr * zr - ti * zi; }
        KD[i] = s; }
    __syncthreads();
    bf16* KT = (bf16*)(F.ws + WS_S5M) + (size_t)g * 196608; bf16* WM = KT + 65536; bf16* VM = KT + 131072;
    for (int pc = tid; pc < 8192; pc += 512) {
        const int row = pc >> 5, col0 = (pc & 31) * 8;
        float kv[8], wv[8], vv[8];
        { const int t = row >> 4, c = row & 15;
#pragma unroll
          for (int j = 0; j < 8; ++j) { const int col = col0 + j, tau = col >> 4, c2 = col & 15; float s = 0.f;
              if (tau <= t) s += KD[((0 * 16 + (t - tau)) * 16 + c) * 16 + c2];
              if (tau >= t) s += KD[((1 * 16 + (tau - t)) * 16 + c) * 16 + c2];
              if (tau == t && c == c2) s += F.d_skip[g * 16 + c];
              kv[j] = s; }
#pragma unroll
          for (int j = 0; j < 8; ++j) { const int col = col0 + j, d = col >> 7, im = (col >> 6) & 1, p = col & 63, f = d == 0 ? t + 1 : 16 - t;
              const float cr = CC[((d * 16 + c) * 64 + p) * 2], ci = CC[((d * 16 + c) * 64 + p) * 2 + 1];
              const float ar = AP[((d * 17 + f) * 64 + p) * 2], ai = AP[((d * 17 + f) * 64 + p) * 2 + 1];
              wv[j] = im ? -(cr * ai + ci * ar) : (cr * ar - ci * ai); } }
        { const int d = row >> 7, im = (row >> 6) & 1, p = row & 63;
#pragma unroll
          for (int j = 0; j < 8; ++j) { const int col = col0 + j, tau = col >> 4, c = col & 15, e = d == 0 ? 15 - tau : tau;
              const float ar = AP[((d * 17 + e) * 64 + p) * 2], ai = AP[((d * 17 + e) * 64 + p) * 2 + 1];
              const float zr = ZB[((d * 64 + p) * 16 + c) * 2], zi = ZB[((d * 64 + p) * 16 + c) * 2 + 1];
              vv[j] = im ? (ar * zi + ai * zr) : (ar * zr - ai * zi); } }
        v4u o; o.x = pk2(kv[0], kv[1]); o.y = pk2(kv[2], kv[3]); o.z = pk2(kv[4], kv[5]); o.w = pk2(kv[6], kv[7]); *(GAS v4u*)(KT + row * 256 + col0) = o;
        o.x = pk2(wv[0], wv[1]); o.y = pk2(wv[2], wv[3]); o.z = pk2(wv[4], wv[5]); o.w = pk2(wv[6], wv[7]); *(GAS v4u*)(WM + row * 256 + col0) = o;
        o.x = pk2(vv[0], vv[1]); o.y = pk2(vv[2], vv[3]); o.z = pk2(vv[4], vv[5]); o.w = pk2(vv[6], vv[7]); *(GAS v4u*)(VM + row * 256 + col0) = o;
    }
    __syncthreads();
}
__device__ __forceinline__ void p0_prologue(Frame& F) {
    for (int g = F.bid; g < NG; g += F.G) s5_setup(F, g);
    LAS float* scr = (LAS float*)(F.lds + F.wave * 16384);
    const int gw = F.bid * NWAVES + F.wave, NGW = F.G * NWAVES;
    bf16* const w_in_t = (bf16*)(F.ws + WS_WIN); bf16* const w_glu_t = (bf16*)(F.ws + WS_WGLU); bf16* const w_sup_t = (bf16*)(F.ws + WS_WSUP); bf16* const w_cup_t = (bf16*)(F.ws + WS_WCUP);
    bf16* const w_o_t = (bf16*)(F.ws + WS_WO); bf16* const w_fin_t = (bf16*)(F.ws + WS_WFIN); bf16* const w_fout_t = (bf16*)(F.ws + WS_WFOUT);
    constexpr int I_IN = (DM / 64) * (INC / 32), I_GLU = (S5W / 64) * (S5W / 32), I_SUP = (S5W / 64) * (DM / 32), I_CUP = (CWID / 64) * (DM / 32), I_O = (DM / 64) * (DM / 32),
                  I_FIN = (DM / 64) * (2 * FH / 32), I_FOUT = (FH / 64) * (DM / 32);
    constexpr int NITEMS = I_IN + I_GLU + I_SUP + I_CUP + I_O + I_FIN + I_FOUT;
    for (int it = gw; it < NITEMS; it += NGW) {
        int r = it;
        if (r < I_IN)  { const int nb = INC / 32;  p0_transpose_item(F.w_in, INC, w_in_t, DM, 64 * (r / nb), 32 * (r % nb), 32 * (r % nb), scr, F.lane); continue; } r -= I_IN;
        if (r < I_GLU) { const int nb = S5W / 32;  p0_transpose_item(F.w_glu, S5W, w_glu_t, S5W, 64 * (r / nb), 32 * (r % nb), 32 * (r % nb), scr, F.lane); continue; } r -= I_GLU;
        if (r < I_SUP) { const int nb = DM / 32;   p0_transpose_item(F.w_sup, DM, w_sup_t, S5W, 64 * (r / nb), 32 * (r % nb), 32 * (r % nb), scr, F.lane); continue; } r -= I_SUP;
        if (r < I_CUP) { const int nb = DM / 32;   p0_transpose_item(F.w_cup, DM, w_cup_t, CWID, 64 * (r / nb), 32 * (r % nb), 32 * (r % nb), scr, F.lane); continue; } r -= I_CUP;
        if (r < I_O)   { const int nb = DM / 32;   p0_transpose_item(F.w_o, DM, w_o_t, DM, 64 * (r / nb), 32 * (r % nb), 32 * (r % nb), scr, F.lane); continue; } r -= I_O;
        if (r < I_FIN) { const int nb = 2 * FH / 32; const int n0 = 32 * (r % nb); const int nn = n0 < FH ? n0 : n0 - FH; const int rb = 256 * (nn / 128) + (nn % 128) + (n0 < FH ? 0 : 128);
                         p0_transpose_item(F.w_fin, 2 * FH, w_fin_t, DM, 64 * (r / nb), n0, rb, scr, F.lane); continue; } r -= I_FIN;
        { const int nb = DM / 32; p0_transpose_item(F.w_fout, DM, w_fout_t, FH, 64 * (r / nb), 32 * (r % nb), 32 * (r % nb), scr, F.lane); }
    }
    bf16* const H = (bf16*)(F.ws + WS_H); bf16* const HM = (bf16*)(F.ws + WS_HM);
    for (int m = gw; m < MT + NMETA; m += NGW) {
        if (m < MT) rms_row_to_bf16(F.x + (size_t)m * DM, F.g_pre, H + (size_t)m * DM, F.lane);
        else rms_row_to_bf16(F.meta + (size_t)(m - MT) * DM, F.g_pre, HM + (size_t)(m - MT) * DM, F.lane);
    }
}
__device__ __forceinline__ f32x4 meta_proj16(const Frame& F, int col0) {
    const int lane = F.lane, l15 = lane & 15, q = lane >> 4;
    const GAS bf16x8* a = (const GAS bf16x8*)((const bf16*)(F.ws + WS_HM) + l15 * DM + 8 * q);
    const GAS bf16x8* b = (const GAS bf16x8*)((const bf16*)(F.ws + WS_WIN) + (size_t)(col0 + l15) * DM + 8 * q);
    f32x4 acc = {0.f, 0.f, 0.f, 0.f};
#pragma unroll 8
    for (int kk = 0; kk < DM / 32; ++kk) acc = __builtin_amdgcn_mfma_f32_16x16x32_bf16(a[kk * 4], b[kk * 4], acc, 0, 0, 0);
    return acc;
}
__device__ __forceinline__ float gelu_tanh(float x) { const float u = 0.7978845608028654f * (x + 0.044715f * x * x * x); const float t = 1.0f - 2.0f * __builtin_amdgcn_rcpf(__expf(2.0f * u) + 1.0f); return 0.5f * x * (1.0f + t); }
__device__ __forceinline__ void s5_unit(Frame& F, int b, int g) {
    LAS unsigned char* L = F.lds;
    const int tid = F.tid, lane = F.lane, wave = F.wave, r = lane & 31, h = lane >> 5;
    LAS float* UM = (LAS float*)(L + S5_UM_OFF); LAS float* EM = (LAS float*)(L + S5_EM_OFF);
    {
        const GAS v4u* src = (const GAS v4u*)((const bf16*)(F.ws + WS_USG) + (size_t)(b * NG + g) * SEQ * 16);
#pragma unroll
        for (int i = 0; i < 8; ++i) { const int idx = tid + 512 * i; const v4u v = src[idx]; *(LAS v4u*)(L + (idx >> 5) * S5_ROW_U + (idx & 31) * 16) = v; }
        if (wave == 0) { const f32x4 d = meta_proj16(F, g * 16);
#pragma unroll
            for (int r4 = 0; r4 < 4; ++r4) UM[(4 * (lane >> 4) + r4) * 16 + (lane & 15)] = d[r4]; }
        if (wave == 1 && b == 0) { const f32x4 dx = meta_proj16(F, S5W + g * 16), dc = meta_proj16(F, 3 * S5W + g * 16);
            if ((lane >> 4) == 3) ((float*)(F.ws + WS_PMETA))[g * 16 + (lane & 15)] = dx[3] * dc[3]; }
    }
    __syncthreads();
    const bf16* KT = (const bf16*)(F.ws + WS_S5M) + (size_t)g * 196608; const bf16* WM = KT + 65536; const bf16* VM = KT + 131072;
    if (tid < 128) {
        const GAS v4u* vr = (const GAS v4u*)(VM + tid * 256); float s = 0.f;
#pragma unroll 4
        for (int q = 0; q < 32; ++q) { const v4u w = vr[q]; const LAS float* um = UM + 8 * q;
            s += bflo(w.x) * um[0] + bfhi(w.x) * um[1] + bflo(w.y) * um[2] + bfhi(w.y) * um[3] + bflo(w.z) * um[4] + bfhi(w.z) * um[5] + bflo(w.w) * um[6] + bfhi(w.w) * um[7]; }
        EM[tid] = s;
    }
    f32x16 accY[4], accE[4];
#pragma unroll
    for (int rt = 0; rt < 4; ++rt)
#pragma unroll
        for (int e = 0; e < 16; ++e) { accY[rt][e] = 0.f; accE[rt][e] = 0.f; }
    const int aoff = r * S5_ROW_U + h * 16;
    {
        const GAS bf16x8* bk = (const GAS bf16x8*)(KT + (32 * wave + r) * 256 + 8 * h);
#pragma unroll 4
        for (int kk = 0; kk < 16; ++kk) { const bf16x8 bfr = bk[kk * 2];
#pragma unroll
            for (int rt = 0; rt < 4; ++rt) { const bf16x8 af = *(const LAS bf16x8*)(L + aoff + rt * (32 * S5_ROW_U) + kk * 32); accY[rt] = __builtin_amdgcn_mfma_f32_32x32x16_bf16(af, bfr, accY[rt], 0, 0, 0); } }
    }
    {
        const GAS bf16x8* bk = (const GAS bf16x8*)(VM + (32 * wave + r) * 256 + 8 * h);
#pragma unroll 4
        for (int kk = 0; kk < 16; ++kk) { const bf16x8 bfr = bk[kk * 2];
#pragma unroll
            for (int rt = 0; rt < 4; ++rt) { const bf16x8 af = *(const LAS bf16x8*)(L + aoff + rt * (32 * S5_ROW_U) + kk * 32); accE[rt] = __builtin_amdgcn_mfma_f32_32x32x16_bf16(af, bfr, accE[rt], 0, 0, 0); } }
    }
    __syncthreads();
#pragma unroll
    for (int rt = 0; rt < 4; ++rt)
#pragma unroll
        for (int e = 0; e < 16; ++e) { const int j = 32 * rt + (e & 3) + 8 * (e >> 2) + 4 * h; *(LAS float*)(L + (j + 1) * S5_ROW_E + (32 * wave + r) * 4) = accE[rt][e]; }
    __syncthreads();
    if (wave < 2) {
        const int p = lane; const float* at = (const float*)(F.ws + WS_S5AT) + ((g * 2 + wave) * 64 + p) * 2; const float ar = at[0], ai = at[1];
        if (wave == 0) {
            float cr = EM[p], ci = EM[64 + p];
#pragma unroll 4
            for (int j = 0; j < 128; ++j) {
                LAS unsigned char* wrow = L + j * S5_ROW_E;
                *(LAS unsigned short*)(wrow + 2 * p) = (unsigned short)f2bf(cr); *(LAS unsigned short*)(wrow + 128 + 2 * p) = (unsigned short)f2bf(ci);
                const LAS float* er = (const LAS float*)(L + (j + 1) * S5_ROW_E); const float e_r = er[p], e_i = er[64 + p];
                const float nr = ar * cr - ai * ci + e_r, ni = ar * ci + ai * cr + e_i; cr = nr; ci = ni; }
        } else {
            float cr = 0.f, ci = 0.f;
#pragma unroll 4
            for (int j = 127; j >= 0; --j) {
                LAS unsigned char* wrow = L + (j + 2) * S5_ROW_E + 512;
                *(LAS unsigned short*)(wrow + 2 * p) = (unsigned short)f2bf(cr); *(LAS unsigned short*)(wrow + 128 + 2 * p) = (unsigned short)f2bf(ci);
                const LAS float* er = (const LAS float*)(L + (j + 1) * S5_ROW_E + 512); const float e_r = er[p], e_i = er[64 + p];
                const float nr = ar * cr - ai * ci + e_r, ni = ar * ci + ai * cr + e_i; cr = nr; ci = ni; }
        }
    }
    __syncthreads();
    {
        const GAS bf16x8* bk = (const GAS bf16x8*)(WM + (32 * wave + r) * 256 + 8 * h);
#pragma unroll 4
        for (int kk = 0; kk < 16; ++kk) { const bf16x8 bfr = bk[kk * 2];
            const LAS unsigned char* base = (kk < 8) ? (L + r * S5_ROW_E + h * 16 + kk * 32) : (L + (r + 2) * S5_ROW_E + 512 + h * 16 + (kk - 8) * 32);
#pragma unroll
            for (int rt = 0; rt < 4; ++rt) { const bf16x8 af = *(const LAS bf16x8*)(base + rt * (32 * S5_ROW_E)); accY[rt] = __builtin_amdgcn_mfma_f32_32x32x16_bf16(af, bfr, accY[rt], 0, 0, 0); } }
    }
    {
        const int t = 2 * wave + (r >> 4), c = r & 15; bf16* ys = (bf16*)(F.ws + WS_YSG) + (size_t)(b * SEQ + t) * S5W + g * 16 + c;
#pragma unroll
        for (int rt = 0; rt < 4; ++rt)
#pragma unroll
            for (int e = 0; e < 16; ++e) { const int j = 32 * rt + (e & 3) + 8 * (e >> 2) + 4 * h; ys[(size_t)(16 * j) * S5W] = (bf16)f2bf(gelu_tanh(accY[rt][e])); }
    }
    __syncthreads();
}
__device__ __forceinline__ void unpack8(const v4u w, float (&o)[8]) { o[0] = bflo(w.x); o[1] = bfhi(w.x); o[2] = bflo(w.y); o[3] = bfhi(w.y); o[4] = bflo(w.z); o[5] = bfhi(w.z); o[6] = bflo(w.w); o[7] = bfhi(w.w); }
__device__ __forceinline__ void conv_unit(Frame& F, int u) {
    const int cg = F.tid & 127, rsub = F.tid >> 7, c0 = cg * 8;
    const bf16* XBC = (const bf16*)(F.ws + WS_XBC); bf16* VB = (bf16*)(F.ws + WS_VB); const float* PM = (const float*)(F.ws + WS_PMETA);
    float w0[8], w1[8], w2[8], bs[8];
#pragma unroll
    for (int j = 0; j < 8; ++j) { w0[j] = F.conv_w[c0 + j]; w1[j] = F.conv_w[CWID + c0 + j]; w2[j] = F.conv_w[2 * CWID + c0 + j]; bs[j] = F.conv_b[c0 + j]; }
    for (int it = 0; it < 16; ++it) {
        const int m = u * 64 + it * 4 + rsub, t = m & (SEQ - 1);
        const bf16* row = XBC + (size_t)m * 3072;
        float xc[8], bc[8], cc[8], cxp[8], cxn[8];
        unpack8(*(const GAS v4u*)(row + c0), xc); unpack8(*(const GAS v4u*)(row + 1024 + c0), bc); unpack8(*(const GAS v4u*)(row + 2048 + c0), cc);
        if (t > 0) { float a[8], bq[8]; unpack8(*(const GAS v4u*)(row - 3072 + c0), a); unpack8(*(const GAS v4u*)(row - 3072 + 2048 + c0), bq);
#pragma unroll
            for (int j = 0; j < 8; ++j) cxp[j] = a[j] * bq[j]; }
        else {
#pragma unroll
            for (int j = 0; j < 8; ++j) cxp[j] = PM[c0 + j]; }
        if (t < SEQ - 1) { float a[8], bq[8]; unpack8(*(const GAS v4u*)(row + 3072 + c0), a); unpack8(*(const GAS v4u*)(row + 3072 + 2048 + c0), bq);
#pragma unroll
            for (int j = 0; j < 8; ++j) cxn[j] = a[j] * bq[j]; }
        else {
#pragma unroll
            for (int j = 0; j < 8; ++j) cxn[j] = 0.f; }
        float o[8];
#pragma unroll
        for (int j = 0; j < 8; ++j) o[j] = bc[j] * (w0[j] * cxp[j] + w1[j] * (cc[j] * xc[j]) + w2[j] * cxn[j] + bs[j]);
        v4u w; w.x = pk2(o[0], o[1]); w.y = pk2(o[2], o[3]); w.z = pk2(o[4], o[5]); w.w = pk2(o[6], o[7]);
        *(GAS v4u*)(VB + (size_t)m * CWID + c0) = w;
    }
}
__device__ __forceinline__ void row_pass_mid(Frame& F, int m) {
    const int lane = F.lane;
    const GAS f32x4* orow = (const GAS f32x4*)((const float*)(F.ws + WS_O) + (size_t)m * DM) + lane; const GAS f32x4* xr = (const GAS f32x4*)(F.x + (size_t)m * DM) + lane;
    const GAS f32x4* g1 = (const GAS f32x4*)F.g_post + lane; const GAS f32x4* g2 = (const GAS f32x4*)F.g_fpre + lane;
    f32x4 v[8]; float s = 0.f;
#pragma unroll
    for (int j = 0; j < 8; ++j) { v[j] = orow[64 * j]; s += (v[j].x * v[j].x + v[j].y * v[j].y) + (v[j].z * v[j].z + v[j].w * v[j].w); }
    const float r1 = 1.0f / sqrtf(wave_sum(s) * (1.f / DM) + RMS_EPS); float s2 = 0.f;
    GAS f32x4* outr = (GAS f32x4*)(F.out + (size_t)m * DM) + lane;
#pragma unroll
    for (int j = 0; j < 8; ++j) { const f32x4 xx = xr[64 * j], gg = g1[64 * j]; v[j] = xx + v[j] * r1 * gg; outr[64 * j] = v[j]; s2 += (v[j].x * v[j].x + v[j].y * v[j].y) + (v[j].z * v[j].z + v[j].w * v[j].w); }
    const float r2 = 1.0f / sqrtf(wave_sum(s2) * (1.f / DM) + RMS_EPS);
    GAS v2u* o8 = (GAS v2u*)((bf16*)(F.ws + WS_H2) + (size_t)m * DM) + lane;
#pragma unroll
    for (int j = 0; j < 8; ++j) { const f32x4 gg = g2[64 * j]; v2u w; w.x = pk2(v[j].x * r2 * gg.x, v[j].y * r2 * gg.y); w.y = pk2(v[j].z * r2 * gg.z, v[j].w * r2 * gg.w); o8[64 * j] = w; }
}
__device__ __forceinline__ void row_pass_end(Frame& F, int m) {
    const int lane = F.lane;
    const GAS f32x4* fr = (const GAS f32x4*)((const float*)(F.ws + WS_O) + (size_t)m * DM) + lane; const GAS f32x4* g1 = (const GAS f32x4*)F.g_fpost + lane;
    f32x4 v[8]; float s = 0.f;
#pragma unroll
    for (int j = 0; j < 8; ++j) { v[j] = fr[64 * j]; s += (v[j].x * v[j].x + v[j].y * v[j].y) + (v[j].z * v[j].z + v[j].w * v[j].w); }
    const float r1 = 1.0f / sqrtf(wave_sum(s) * (1.f / DM) + RMS_EPS);
    GAS f32x4* outr = (GAS f32x4*)(F.out + (size_t)m * DM) + lane;
#pragma unroll
    for (int j = 0; j < 8; ++j) { const f32x4 hh = outr[64 * j], gg = g1[64 * j]; outr[64 * j] = hh + v[j] * r1 * gg; }
}


#ifndef SLOW_MASK
#define SLOW_MASK 0
#endif
template <class Fn>
__device__ __forceinline__ void slow_gemm(const Frame& F, const bf16* A1, const bf16* B1, const bf16* A2, const bf16* B2, int M, int N, int K, int bmode, const Fn& fn) {
    const int lane = F.lane, l15 = lane & 15, q = lane >> 4;
    const int gw = F.bid * NWAVES + F.wave, NGW = F.G * NWAVES, nct = N / 16, ntask = (M / 16) * nct;
    for (int task = gw; task < ntask; task += NGW) {
        const int rt = task / nct, ct = task % nct, col = ct * 16 + l15;
        const int br1 = bmode ? (256 * (col >> 7) + (col & 127)) : col, br2 = bmode ? br1 + 128 : col;
        const GAS bf16x8* a1 = (const GAS bf16x8*)(A1 + (size_t)(rt * 16 + l15) * K + 8 * q);
        const GAS bf16x8* b1 = (const GAS bf16x8*)(B1 + (size_t)br1 * K + 8 * q);
        const GAS bf16x8* a2 = (const GAS bf16x8*)((A2 ? A2 : A1) + (size_t)(rt * 16 + l15) * K + 8 * q);
        const GAS bf16x8* b2 = (const GAS bf16x8*)((B2 ? B2 : B1) + (size_t)br2 * K + 8 * q);
        f32x4 c1 = {0.f, 0.f, 0.f, 0.f}, c2 = {0.f, 0.f, 0.f, 0.f};
#pragma unroll 4
        for (int kk = 0; kk < K / 32; ++kk) { c1 = __builtin_amdgcn_mfma_f32_16x16x32_bf16(a1[kk * 4], b1[kk * 4], c1, 0, 0, 0);
            if (B2) c2 = __builtin_amdgcn_mfma_f32_16x16x32_bf16(a2[kk * 4], b2[kk * 4], c2, 0, 0, 0); }
#pragma unroll
        for (int r = 0; r < 4; ++r) fn(rt * 16 + 4 * q + r, col, c1[r], c2[r]);
    }
}
struct SlowInProj { bf16* usg; bf16* xbc; bf16* gates; const float* gate_b;
    __device__ __forceinline__ void operator()(int row, int col, float a, float) const {
        if (col < 1024) { const int b = row >> 11, t = row & 2047; usg[((size_t)((b * NG + (col >> 4)) * SEQ + t)) * 16 + (col & 15)] = (bf16)f2bf(a); }
        else if (col < 4096) xbc[(size_t)row * 3072 + col - 1024] = (bf16)f2bf(a);
        else gates[(size_t)row * 4096 + col - 4096] = (bf16)f2bf(1.0f / (1.0f + expf(-(a + gate_b[col - 4096])))); } };
struct SlowGlu { const bf16* ysg; bf16* z; const float* b_glu;
    __device__ __forceinline__ void operator()(int row, int col, float a, float) const { const float y = bflo((unsigned)ysg[(size_t)row * S5W + col]); z[(size_t)row * S5W + col] = (bf16)f2bf(y / (1.0f + expf(-(a + b_glu[col])))); } };
struct SlowMerge { const bf16* gates; bf16* merged;
    __device__ __forceinline__ void operator()(int row, int col, float a, float c) const { const float gs = bflo((unsigned)gates[(size_t)row * 4096 + col]), gc = bflo((unsigned)gates[(size_t)row * 4096 + 2048 + col]); merged[(size_t)row * DM + col] = (bf16)f2bf(gs * a + gc * c); } };
struct SlowF32 { float* C;
    __device__ __forceinline__ void operator()(int row, int col, float a, float) const { C[(size_t)row * DM + col] = a; } };
struct SlowSwi { bf16* act;
    __device__ __forceinline__ void operator()(int row, int col, float g, float u) const { act[(size_t)row * FH + col] = (bf16)f2bf(g / (1.0f + expf(-g)) * u); } };

constexpr int NPHASES = 10;
__global__ void __launch_bounds__(NWAVES * 64, 2) hybrid_fwd(Args args) {
    extern __shared__ __attribute__((aligned(16))) unsigned char lds[];
    Frame F;
    F.lds = (LAS unsigned char*)lds;
    F.tid = threadIdx.x; F.lane = F.tid & 63; F.wave = __builtin_amdgcn_readfirstlane(F.tid >> 6);
    F.G = gridDim.x; F.bid = blockIdx.x;
    F.x = args.in[0]; F.meta = args.in[1]; F.g_pre = args.in[2]; F.g_post = args.in[3]; F.g_fpre = args.in[4]; F.g_fpost = args.in[5]; F.w_in = args.in[6]; F.gate_b = args.in[7];
    F.lam_re = args.in[8]; F.lam_im = args.in[9]; F.log_dt = args.in[10]; F.b_re = args.in[11]; F.b_im = args.in[12]; F.c_re = args.in[13]; F.c_im = args.in[14]; F.d_skip = args.in[15];
    F.w_glu = args.in[16]; F.b_glu = args.in[17]; F.w_sup = args.in[18]; F.conv_w = args.in[19]; F.conv_b = args.in[20]; F.w_cup = args.in[21]; F.w_o = args.in[22]; F.w_fin = args.in[23]; F.w_fout = args.in[24];
    F.out = args.out; F.ws = args.ws;
    for (int u = F.tid; u < (LDS_BYTES - LDSCTL_OFF) / 4; u += NWAVES * 64) ((LAS unsigned*)(F.lds + LDSCTL_OFF))[u] = 0u;
    __syncthreads();
    const int lo = args.ph_lo, hi = args.ph_hi;
    XcdBarrier bar; bar.bar = (unsigned*)(F.ws + WS_CTL) + CW_BAR; bar.x = 0; bar.st = nullptr;
    if (hi - lo > 1) bar = xcd_barrier_post((unsigned*)(F.ws + WS_CTL) + CW_BAR, (volatile LAS unsigned*)(F.lds + MISC_OFF) + 8);
#define IN(k) (lo <= (k) && (k) < hi)
#define SEAM(k) do { if (IN(k) && IN((k) + 1)) xcd_barrier(bar); } while (0)
    const int gw = F.bid * NWAVES + F.wave, NGW = F.G * NWAVES;
    LAS unsigned char* ring = F.lds;

    if (IN(0)) { p0_prologue(F); SEAM(0); }

    if (IN(1)) {
        pg8::Gemm g{(const bf16*)(F.ws + WS_H), nullptr, (const bf16*)(F.ws + WS_WIN), nullptr, MT, INC, DM}; pg8::StaticOrder S; S.init(MT, INC, F.G, F.bid);
        pg8::EpiInProj E{(bf16*)(F.ws + WS_USG), (bf16*)(F.ws + WS_XBC), (bf16*)(F.ws + WS_GATES), F.gate_b};
        pg8::gemm_phase<pg8::EpiInProj, pg8::StaticOrder, true, true, 1>(ring, g, S, E);
        SEAM(1);
    }
    if (IN(2)) {
        for (int u = F.bid; u < NB * NG; u += F.G) s5_unit(F, u >> 6, u & 63);
        SEAM(2);
    }
    if (IN(3)) {
        pg8::Gemm g{(const bf16*)(F.ws + WS_YSG), nullptr, (const bf16*)(F.ws + WS_WGLU), nullptr, MT, S5W, S5W}; pg8::StaticOrder S; S.init(MT, S5W, F.G, F.bid);
        pg8::EpiGlu E{(const bf16*)(F.ws + WS_YSG), (bf16*)(F.ws + WS_Z), F.b_glu};
        if (SLOW_MASK & (1 << 3)) { slow_gemm(F, (const bf16*)(F.ws + WS_YSG), (const bf16*)(F.ws + WS_WGLU), nullptr, nullptr, MT, S5W, S5W, 0, SlowGlu{(const bf16*)(F.ws + WS_YSG), (bf16*)(F.ws + WS_Z), F.b_glu}); } else
        pg8::gemm_phase<pg8::EpiGlu, pg8::StaticOrder, false, true, 1>(ring, g, S, E);
        const int cfirst = F.G > 128 ? 128 : 0, ncw = F.G - cfirst;
        if (F.bid >= cfirst) for (int u = F.bid - cfirst; u < 128; u += ncw) conv_unit(F, u);
        SEAM(3);
    }
    if (IN(4)) {
        pg8::Gemm g{(const bf16*)(F.ws + WS_Z), (const bf16*)(F.ws + WS_VB), (const bf16*)(F.ws + WS_WSUP), (const bf16*)(F.ws + WS_WCUP), MT, DM, S5W}; pg8::StaticOrder S; S.init(MT, DM, F.G, F.bid);
        pg8::EpiMerge E{(const bf16*)(F.ws + WS_GATES), (bf16*)(F.ws + WS_MERGED)};
        if (SLOW_MASK & (1 << 4)) { slow_gemm(F, (const bf16*)(F.ws + WS_Z), (const bf16*)(F.ws + WS_WSUP), (const bf16*)(F.ws + WS_VB), (const bf16*)(F.ws + WS_WCUP), MT, DM, S5W, 0, SlowMerge{(const bf16*)(F.ws + WS_GATES), (bf16*)(F.ws + WS_MERGED)}); } else
        pg8::gemm_phase<pg8::EpiMerge, pg8::StaticOrder, false, true, 2>(ring, g, S, E);
        SEAM(4);
    }
    if (IN(5)) {
        pg8::Gemm g{(const bf16*)(F.ws + WS_MERGED), nullptr, (const bf16*)(F.ws + WS_WO), nullptr, MT, DM, DM}; pg8::StaticOrder S; S.init(MT, DM, F.G, F.bid);
        pg8::EpiF32 E{(float*)(F.ws + WS_O), DM};
        if (SLOW_MASK & (1 << 5)) { slow_gemm(F, (const bf16*)(F.ws + WS_MERGED), (const bf16*)(F.ws + WS_WO), nullptr, nullptr, MT, DM, DM, 0, SlowF32{(float*)(F.ws + WS_O)}); } else
        pg8::gemm_phase<pg8::EpiF32, pg8::StaticOrder, false, true, 1>(ring, g, S, E);
        SEAM(5);
    }
    if (IN(6)) { for (int m = gw; m < MT; m += NGW) row_pass_mid(F, m); SEAM(6); }
    if (IN(7)) {
        pg8::Gemm g{(const bf16*)(F.ws + WS_H2), nullptr, (const bf16*)(F.ws + WS_WFIN), nullptr, MT, 2 * FH, DM}; pg8::StaticOrder S; S.init(MT, 2 * FH, F.G, F.bid);
        pg8::EpiSwiGlu E{(bf16*)(F.ws + WS_ACT)};
        if (SLOW_MASK & (1 << 7)) { slow_gemm(F, (const bf16*)(F.ws + WS_H2), (const bf16*)(F.ws + WS_WFIN), (const bf16*)(F.ws + WS_H2), (const bf16*)(F.ws + WS_WFIN), MT, FH, DM, 1, SlowSwi{(bf16*)(F.ws + WS_ACT)}); } else
        pg8::gemm_phase<pg8::EpiSwiGlu, pg8::StaticOrder, true, true, 1>(ring, g, S, E);
        SEAM(7);
    }
    if (IN(8)) {
        pg8::Gemm g{(const bf16*)(F.ws + WS_ACT), nullptr, (const bf16*)(F.ws + WS_WFOUT), nullptr, MT, DM, FH}; pg8::StaticOrder S; S.init(MT, DM, F.G, F.bid);
        pg8::EpiF32 E{(float*)(F.ws + WS_O), DM};
        if (SLOW_MASK & (1 << 8)) { slow_gemm(F, (const bf16*)(F.ws + WS_ACT), (const bf16*)(F.ws + WS_WFOUT), nullptr, nullptr, MT, DM, FH, 0, SlowF32{(float*)(F.ws + WS_O)}); } else
        pg8::gemm_phase<pg8::EpiF32, pg8::StaticOrder, false, true, 1>(ring, g, S, E);
        SEAM(8);
    }
    if (IN(9)) { for (int m = gw; m < MT; m += NGW) row_pass_end(F, m); }
#undef IN
#undef SEAM
}

extern "C" void kernel_launch(void* const* d_in, const int* in_sizes, int n_in, void* d_out, int out_size, void* d_ws, size_t ws_size, hipStream_t stream) {
    static int grid = 0;
    if (grid == 0) {
        if (n_in != 25 || in_sizes[0] != MT * DM || out_size != MT * DM || ws_size < WS_END) { fprintf(stderr, "kernel_launch: unexpected shapes (n_in %d, in0 %d, out %d, ws %zu < %zu); nothing launched\n", n_in, n_in > 0 ? in_sizes[0] : -1, out_size, ws_size, (size_t)WS_END); grid = -1; return; }
        int dev = 0, cus = 0, per_cu = 0;
        if (hipGetDevice(&dev) != hipSuccess || hipDeviceGetAttribute(&cus, hipDeviceAttributeMultiprocessorCount, dev) != hipSuccess) { fprintf(stderr, "kernel_launch: device query failed\n"); grid = -1; return; }
        if (hipFuncSetAttribute((const void*)hybrid_fwd, hipFuncAttributeMaxDynamicSharedMemorySize, LDS_BYTES) != hipSuccess) { fprintf(stderr, "kernel_launch: hipFuncSetAttribute failed\n"); grid = -1; return; }
        if (hipOccupancyMaxActiveBlocksPerMultiprocessor(&per_cu, (const void*)hybrid_fwd, NWAVES * 64, LDS_BYTES) != hipSuccess || per_cu < 1) { fprintf(stderr, "kernel_launch: occupancy query reports %d workgroups per CU\n", per_cu); (void)hipGetLastError(); per_cu = 1; }
        grid = cus;
    }
    if (grid < 0) return;
    (void)hipMemsetAsync((char*)d_ws + WS_CTL, 0, CTL_ZERO_BYTES, stream);
    Args a{};
    for (int i = 0; i < 25; ++i) a.in[i] = (const float*)d_in[i];
    a.out = (float*)d_out; a.ws = (unsigned char*)d_ws;
    if (MK_N_LAUNCHES == 1) { a.ph_lo = 0; a.ph_hi = NPHASES; hipLaunchKernelGGL(hybrid_fwd, dim3(grid), dim3(NWAVES * 64), LDS_BYTES, stream, a); }
    else for (int p = 0; p < NPHASES; ++p) { a.ph_lo = p; a.ph_hi = p + 1; hipLaunchKernelGGL(hybrid_fwd, dim3(grid), dim3(NWAVES * 64), LDS_BYTES, stream, a); }
}
```
